# Optimizing an MI355X kernel written in HIP

```python
import math
import jax, jax.numpy as jnp
from jax import lax
import numpy as np

D_MODEL = 1024
BATCH = 16
SEQ = 2048
DEPTH = 1

D_MIX = D_MODEL
D_SSM = D_MIX // 2
D_ATTN = D_MIX - D_SSM
SSM_GROUP = 16
N_SSM_GROUPS = D_SSM // SSM_GROUP
SSM_STATE = 64
DT_MIN = 1e-3
DT_MAX = 1e-1
HEAD_DIM = 64
N_HEADS = D_ATTN // HEAD_DIM
MOBA_BLOCK = 256
MOBA_TOPK = 3
Q_CHUNK = 16
D_FF = -(-8 * D_MODEL // (3 * 256)) * 256
RMS_EPS = 1e-6

kernel_name = "hybrid_s5_moba_block"


def rmsnorm(x, g):
    xf = x.astype(jnp.float32)
    y = xf * lax.rsqrt(jnp.mean(xf * xf, axis=-1, keepdims=True) + RMS_EPS)
    return (y * g.astype(jnp.float32)).astype(x.dtype)


def _complex_affine_combine(e1, e2):
    a1r, a1i, b1r, b1i = e1
    a2r, a2i, b2r, b2i = e2
    ar = a2r * a1r - a2i * a1i
    ai = a2r * a1i + a2i * a1r
    br = a2r * b1r - a2i * b1i + b2r
    bi = a2r * b1i + a2i * b1r + b2i
    return (ar, ai, br, bi)


def s5_mixer(u, a_re, a_im, log_dt, b_re, b_im, c_re, c_im, d_skip, w_glu, b_glu):
    bsz, s, _ = u.shape
    f32 = jnp.float32
    uf = u.astype(f32).reshape(bsz, s, N_SSM_GROUPS, SSM_GROUP)
    a_re = a_re.astype(f32); a_im = a_im.astype(f32)
    dt = jnp.exp(log_dt.astype(f32))[:, None]
    mag = jnp.exp(a_re * dt)
    ang = a_im * dt
    lb_re = mag * jnp.cos(ang)
    lb_im = mag * jnp.sin(ang)
    nr = lb_re - 1.0
    den = a_re * a_re + a_im * a_im
    cr = (nr * a_re + lb_im * a_im) / den
    ci = (lb_im * a_re - nr * a_im) / den
    b_re = b_re.astype(f32); b_im = b_im.astype(f32)
    bb_re = cr[..., None] * b_re - ci[..., None] * b_im
    bb_im = cr[..., None] * b_im + ci[..., None] * b_re
    bu_re = jnp.einsum('bsgh,gph->bsgp', uf, bb_re)
    bu_im = jnp.einsum('bsgh,gph->bsgp', uf, bb_im)
    ar = jnp.broadcast_to(lb_re, (1, s) + lb_re.shape)
    ai = jnp.broadcast_to(lb_im, (1, s) + lb_im.shape)
    _, _, st_re, st_im = lax.associative_scan(
        _complex_affine_combine, (ar, ai, bu_re, bu_im), axis=1)
    y = (jnp.einsum('bsgp,ghp->bsgh', st_re, c_re.astype(f32))
         - jnp.einsum('bsgp,ghp->bsgh', st_im, c_im.astype(f32))
         + d_skip.astype(f32) * uf)
    y = jax.nn.gelu(y.reshape(bsz, s, D_SSM))
    y = y * jax.nn.sigmoid(jnp.einsum('bsc,ce->bse', y, w_glu.astype(f32)) + b_glu.astype(f32))
    return y.astype(u.dtype)


def moba_attention(q, k, v):
    bsz, s, _ = q.shape
    n_blocks = -(-s // MOBA_BLOCK)
    sp = n_blocks * MOBA_BLOCK
    k_sel = min(MOBA_TOPK, n_blocks)
    n_chunks = sp // Q_CHUNK

    def heads(t):
        t = t.astype(jnp.float32).reshape(bsz, s, N_HEADS, HEAD_DIM).transpose(0, 2, 1, 3)
        return jnp.pad(t, ((0, 0), (0, 0), (0, sp - s), (0, 0)))

    qh = heads(q) * (HEAD_DIM ** -0.5)
    kh = heads(k)
    vh = heads(v)
    k_blocks = kh.reshape(bsz, N_HEADS, n_blocks, MOBA_BLOCK, HEAD_DIM)
    v_blocks = vh.reshape(bsz, N_HEADS, n_blocks, MOBA_BLOCK, HEAD_DIM)
    k_mean = jnp.mean(k_blocks, axis=3)

    gate = jnp.einsum('bhsd,bhnd->bhsn', qh, k_mean)
    q_blk = jnp.arange(sp) // MOBA_BLOCK
    past = jnp.arange(n_blocks)[None, :] < q_blk[:, None]
    gate = jnp.where(past, gate, -jnp.inf)
    _, sel_idx = lax.top_k(gate, k_sel)
    sel_valid = jnp.arange(k_sel)[None, :] < q_blk[:, None]

    def to_chunks(t):
        return jnp.moveaxis(t.reshape(bsz, N_HEADS, n_chunks, Q_CHUNK, *t.shape[3:]), 2, 0)

    q_c = to_chunks(qh)
    idx_c = to_chunks(sel_idx)
    valid_c = sel_valid.reshape(n_chunks, Q_CHUNK, k_sel)
    gather = jax.vmap(jax.vmap(lambda blocks, ix: blocks[ix]))

    def chunk_attend(args):
        c, qc, ic, vc = args
        kg = gather(k_blocks, ic)
        vg = gather(v_blocks, ic)
        s_sel = jnp.einsum('bhqd,bhqnjd->bhqnj', qc, kg)
        s_sel = jnp.where(vc[None, None, :, :, None], s_sel, -jnp.inf)
        own = (c * Q_CHUNK) // MOBA_BLOCK
        k_own = lax.dynamic_index_in_dim(k_blocks, own, axis=2, keepdims=False)
        v_own = lax.dynamic_index_in_dim(v_blocks, own, axis=2, keepdims=False)
        s_own = jnp.einsum('bhqd,bhjd->bhqj', qc, k_own)
        q_pos = c * Q_CHUNK + jnp.arange(Q_CHUNK)
        k_pos = own * MOBA_BLOCK + jnp.arange(MOBA_BLOCK)
        s_own = jnp.where(k_pos[None, :] <= q_pos[:, None], s_own, -jnp.inf)
        scores = jnp.concatenate(
            [s_sel.reshape(bsz, N_HEADS, Q_CHUNK, k_sel * MOBA_BLOCK), s_own], axis=-1)
        p = jax.nn.softmax(scores, axis=-1)
        p_sel = p[..., :k_sel * MOBA_BLOCK].reshape(bsz, N_HEADS, Q_CHUNK, k_sel, MOBA_BLOCK)
        p_own = p[..., k_sel * MOBA_BLOCK:]
        return (jnp.einsum('bhqnj,bhqnjd->bhqd', p_sel, vg)
                + jnp.einsum('bhqj,bhjd->bhqd', p_own, v_own))

    out = lax.map(chunk_attend, (jnp.arange(n_chunks), q_c, idx_c, valid_c))
    out = out.transpose(1, 0, 3, 2, 4).reshape(bsz, sp, D_ATTN)
    return out[:, :s].astype(q.dtype)


def hybrid_layer(x, g_pre_mix, w_in, ssm_a_re, ssm_a_im, ssm_log_dt, ssm_b_re, ssm_b_im,
                 ssm_c_re, ssm_c_im, ssm_d, w_glu, b_glu, g_ssm_out, g_attn_out, w_out,
                 g_post_mix, g_pre_ffn, w_gate, w_up, w_down, g_post_ffn):
    h = rmsnorm(x, g_pre_mix)
    z = jnp.einsum('bsd,de->bse', h, w_in)
    u, q, k, v = jnp.split(z, [D_SSM, D_SSM + D_ATTN, D_SSM + 2 * D_ATTN], axis=-1)
    y_ssm = s5_mixer(u, ssm_a_re, ssm_a_im, ssm_log_dt, ssm_b_re, ssm_b_im,
                     ssm_c_re, ssm_c_im, ssm_d, w_glu, b_glu)
    y_attn = moba_attention(q, k, v)
    mix = jnp.concatenate([rmsnorm(y_ssm, g_ssm_out), rmsnorm(y_attn, g_attn_out)], axis=-1)
    x = x + rmsnorm(jnp.einsum('bse,ed->bsd', mix, w_out), g_post_mix)
    h = rmsnorm(x, g_pre_ffn)
    f = jax.nn.silu(jnp.einsum('bsd,df->bsf', h, w_gate)) * jnp.einsum('bsd,df->bsf', h, w_up)
    x = x + rmsnorm(jnp.einsum('bsf,fd->bsd', f, w_down), g_post_ffn)
    return x


def setup_inputs(seed: int = 0) -> dict:
    key = jax.random.key(seed)
    ks = jax.random.split(key, 24)
    f32 = jnp.float32
    G, P, H = N_SSM_GROUPS, SSM_STATE, SSM_GROUP
    L = DEPTH

    def nrm(k, shape, scale):
        return jax.random.normal(k, shape, f32) * scale

    def gain(k, n):
        return 1.0 + 0.01 * jax.random.normal(k, (L, n), f32)

    n_idx = jnp.arange(P, dtype=f32)
    return dict(
        x=nrm(ks[0], (BATCH, SEQ, D_MODEL), 1.0),
        g_pre_mix=gain(ks[1], D_MODEL),
        w_in=nrm(ks[2], (L, D_MODEL, D_SSM + 3 * D_ATTN), D_MODEL ** -0.5),
        ssm_a_re=-0.5 + nrm(ks[3], (L, G, P), 0.01),
        ssm_a_im=math.pi * n_idx[None, None, :] + nrm(ks[4], (L, G, P), 0.01),
        ssm_log_dt=jax.random.uniform(ks[5], (L, G), f32, minval=math.log(DT_MIN), maxval=math.log(DT_MAX)),
        ssm_b_re=nrm(ks[6], (L, G, P, H), (2 * H) ** -0.5),
        ssm_b_im=nrm(ks[7], (L, G, P, H), (2 * H) ** -0.5),
        ssm_c_re=nrm(ks[8], (L, G, H, P), (2 * P) ** -0.5),
        ssm_c_im=nrm(ks[9], (L, G, H, P), (2 * P) ** -0.5),
        ssm_d=nrm(ks[10], (L, G, H), 1.0),
        w_glu=nrm(ks[11], (L, D_SSM, D_SSM), D_SSM ** -0.5),
        b_glu=nrm(ks[12], (L, D_SSM), 0.01),
        g_ssm_out=gain(ks[13], D_SSM),
        g_attn_out=gain(ks[14], D_ATTN),
        w_out=nrm(ks[15], (L, D_MIX, D_MODEL), D_MIX ** -0.5),
        g_post_mix=gain(ks[16], D_MODEL),
        g_pre_ffn=gain(ks[17], D_MODEL),
        w_gate=nrm(ks[18], (L, D_MODEL, D_FF), D_MODEL ** -0.5),
        w_up=nrm(ks[19], (L, D_MODEL, D_FF), D_MODEL ** -0.5),
        w_down=nrm(ks[20], (L, D_FF, D_MODEL), D_FF ** -0.5),
        g_post_ffn=gain(ks[21], D_MODEL),
    )


def reference(x, g_pre_mix, w_in, ssm_a_re, ssm_a_im, ssm_log_dt, ssm_b_re, ssm_b_im,
              ssm_c_re, ssm_c_im, ssm_d, w_glu, b_glu, g_ssm_out, g_attn_out, w_out,
              g_post_mix, g_pre_ffn, w_gate, w_up, w_down, g_post_ffn):
    for l in range(DEPTH):
        x = hybrid_layer(x, g_pre_mix[l], w_in[l], ssm_a_re[l], ssm_a_im[l], ssm_log_dt[l],
                         ssm_b_re[l], ssm_b_im[l], ssm_c_re[l], ssm_c_im[l], ssm_d[l],
                         w_glu[l], b_glu[l], g_ssm_out[l], g_attn_out[l], w_out[l],
                         g_post_mix[l], g_pre_ffn[l], w_gate[l], w_up[l], w_down[l], g_post_ffn[l])
    return x
```

```cpp
#include <hip/hip_runtime.h>
#include <cstdio>
#include <cstdint>
#include <cmath>

namespace gold {
constexpr int BATCH = 16, SEQ = 2048, DM = 1024, M = BATCH * SEQ, DSSM = 512, DATT = 512;
constexpr int NG = 32, GH = 16, NP = 64, NH = 8, HD = 64, BLK = 256, NB = 8, DFF = 2816, NZ = 2048;
constexpr float EPS = 1e-6f;

__global__ __launch_bounds__(256) void rmsnorm_kernel(const float* __restrict__ x, int ldx, const float* __restrict__ g, const float* base, int ldb,
                                                      float* out, int ldo, int D) {
    const int row = blockIdx.x * 4 + (threadIdx.x >> 6), lane = threadIdx.x & 63;
    const float* xr = x + (size_t)row * ldx;
    float s = 0.f;
    for (int i = lane; i < D; i += 64) { const float v = xr[i]; s += v * v; }
#pragma unroll
    for (int o = 32; o > 0; o >>= 1) s += __shfl_xor(s, o);
    const float r = 1.0f / sqrtf(s / (float)D + EPS);
    for (int i = lane; i < D; i += 64) {
        float v = xr[i] * r * g[i];
        if (base) v += base[(size_t)row * ldb + i];
        out[(size_t)row * ldo + i] = v;
    }
}

__global__ __launch_bounds__(256) void gemm_f32(const float* __restrict__ A, int lda, const float* __restrict__ B, int ldb, float* __restrict__ C, int ldc, int K) {
    __shared__ float As[8][128 + 4];
    __shared__ float Bs[8][128 + 4];
    const int tid = threadIdx.x, tx = tid & 15, ty = tid >> 4;
    const int m0 = blockIdx.y * 128, n0 = blockIdx.x * 128;
    float acc[8][8];
#pragma unroll
    for (int i = 0; i < 8; ++i)
#pragma unroll
        for (int j = 0; j < 8; ++j) acc[i][j] = 0.f;
    for (int k0 = 0; k0 < K; k0 += 8) {
#pragma unroll
        for (int i = 0; i < 4; ++i) { const int idx = tid + i * 256, mm = idx >> 3, kk = idx & 7; As[kk][mm] = A[(size_t)(m0 + mm) * lda + k0 + kk]; }
#pragma unroll
        for (int i = 0; i < 4; ++i) { const int idx = tid + i * 256, kk = idx >> 7, nn = idx & 127; Bs[kk][nn] = B[(size_t)(k0 + kk) * ldb + n0 + nn]; }
        __syncthreads();
#pragma unroll
        for (int kk = 0; kk < 8; ++kk) {
            float a[8], b[8];
#pragma unroll
            for (int i = 0; i < 4; ++i) { a[i] = As[kk][ty * 4 + i]; a[4 + i] = As[kk][64 + ty * 4 + i]; b[i] = Bs[kk][tx * 4 + i]; b[4 + i] = Bs[kk][64 + tx * 4 + i]; }
#pragma unroll
            for (int i = 0; i < 8; ++i)
#pragma unroll
                for (int j = 0; j < 8; ++j) acc[i][j] = fmaf(a[i], b[j], acc[i][j]);
        }
        __syncthreads();
    }
#pragma unroll
    for (int i = 0; i < 8; ++i) {
        const int r = m0 + (i < 4 ? ty * 4 + i : 64 + ty * 4 + (i - 4));
#pragma unroll
        for (int j = 0; j < 8; ++j) { const int c = n0 + (j < 4 ? tx * 4 + j : 64 + tx * 4 + (j - 4)); C[(size_t)r * ldc + c] = acc[i][j]; }
    }
}

__global__ void s5_const_kernel(const float* a_re, const float* a_im, const float* log_dt, const float* b_re, const float* b_im,
                                float* lam, float* bb_re, float* bb_im) {
    const int i = blockIdx.x * blockDim.x + threadIdx.x;
    if (i >= NG * NP) return;
    const int g = i / NP;
    const double dt = exp((double)log_dt[g]);
    const double ar = a_re[i], ai = a_im[i];
    const double mag = exp(ar * dt), ang = ai * dt;
    const double lr = mag * cos(ang), li = mag * sin(ang);
    const double nr = lr - 1.0, den = ar * ar + ai * ai;
    const double cr = (nr * ar + li * ai) / den, ci = (li * ar - nr * ai) / den;
    lam[2 * i] = (float)lr; lam[2 * i + 1] = (float)li;
    for (int h = 0; h < GH; ++h) {
        const double br = b_re[i * GH + h], bi = b_im[i * GH + h];
        bb_re[i * GH + h] = (float)(cr * br - ci * bi);
        bb_im[i * GH + h] = (float)(cr * bi + ci * br);
    }
}

__device__ __forceinline__ float gelu_tanh(float x) {
    const float k0 = 0.7978845608028654f, k1 = 0.044715f;
    const float t = tanhf(k0 * (x + k1 * x * x * x));
    return 0.5f * x * (1.0f + t);
}

__global__ __launch_bounds__(64) void s5_scan_kernel(const float* __restrict__ Z  , const float* __restrict__ lam, const float* __restrict__ bb_re,
                                                     const float* __restrict__ bb_im, const float* __restrict__ c_re, const float* __restrict__ c_im,
                                                     const float* __restrict__ d_skip, float* __restrict__ Y  ) {
    const int g = blockIdx.x, b = blockIdx.y, p = threadIdx.x, lane = threadIdx.x;
    const float lr = lam[2 * (g * NP + p)], li = lam[2 * (g * NP + p) + 1];
    float br[GH], bi[GH], cr[GH], ci[GH];
#pragma unroll
    for (int h = 0; h < GH; ++h) {
        br[h] = bb_re[(g * NP + p) * GH + h]; bi[h] = bb_im[(g * NP + p) * GH + h];
        cr[h] = c_re[(g * GH + h) * NP + p]; ci[h] = c_im[(g * GH + h) * NP + p];
    }
    const int hl = ((lane >> 2) & 1) + 2 * ((lane >> 3) & 1) + 4 * ((lane >> 4) & 1) + 8 * ((lane >> 5) & 1);
    const float dsk = d_skip[g * GH + hl];
    float sr = 0.f, si = 0.f;
    const float* zb = Z + (size_t)b * SEQ * NZ + g * GH;
    float* yb = Y + (size_t)b * SEQ * DSSM + g * GH;
    for (int s0 = 0; s0 < SEQ; s0 += 4) {
        const float uv = zb[(size_t)(s0 + (lane >> 4)) * NZ + (lane & 15)];
#pragma unroll
        for (int st = 0; st < 4; ++st) {
            float u[GH];
#pragma unroll
            for (int h = 0; h < GH; ++h) u[h] = __shfl(uv, st * 16 + h);
            float bur = 0.f, bui = 0.f;
#pragma unroll
            for (int h = 0; h < GH; ++h) { bur = fmaf(br[h], u[h], bur); bui = fmaf(bi[h], u[h], bui); }
            const float nsr = lr * sr - li * si + bur, nsi = lr * si + li * sr + bui;
            sr = nsr; si = nsi;
            float v[GH];
#pragma unroll
            for (int h = 0; h < GH; ++h) v[h] = sr * cr[h] - si * ci[h];
            float w8[8];
#pragma unroll
            for (int i = 0; i < 8; ++i) { const bool up = (lane & 32) != 0; const float send = up ? v[i] : v[i + 8], keep = up ? v[i + 8] : v[i]; w8[i] = keep + __shfl_xor(send, 32); }
            float w4[4];
#pragma unroll
            for (int i = 0; i < 4; ++i) { const bool up = (lane & 16) != 0; const float send = up ? w8[i] : w8[i + 4], keep = up ? w8[i + 4] : w8[i]; w4[i] = keep + __shfl_xor(send, 16); }
            float w2[2];
#pragma unroll
            for (int i = 0; i < 2; ++i) { const bool up = (lane & 8) != 0; const float send = up ? w4[i] : w4[i + 2], keep = up ? w4[i + 2] : w4[i]; w2[i] = keep + __shfl_xor(send, 8); }
            float w1;
            { const bool up = (lane & 4) != 0; const float send = up ? w2[0] : w2[1], keep = up ? w2[1] : w2[0]; w1 = keep + __shfl_xor(send, 4); }
            w1 += __shfl_xor(w1, 2); w1 += __shfl_xor(w1, 1);
            float uh = 0.f;
#pragma unroll
            for (int h = 0; h < GH; ++h) uh = (hl == h) ? u[h] : uh;
            if ((lane & 3) == 0) yb[(size_t)(s0 + st) * DSSM + hl] = gelu_tanh(w1 + dsk * uh);
        }
    }
}

__global__ void glu_kernel(float* y, const float* gate, const float* b_glu, size_t n) {
    const size_t i = (size_t)blockIdx.x * blockDim.x + threadIdx.x;
    if (i >= n) return;
    const float gv = gate[i] + b_glu[i % DSSM];
    y[i] = y[i] * (1.0f / (1.0f + expf(-gv)));
}

__global__ void swiglu_kernel(float* g, const float* u, size_t n) {
    const size_t i = (size_t)blockIdx.x * blockDim.x + threadIdx.x;
    if (i >= n) return;
    const float gv = g[i];
    g[i] = gv / (1.0f + expf(-gv)) * u[i];
}

__global__ __launch_bounds__(64) void kmean_kernel(const float* __restrict__ Z, float* __restrict__ kmean) {
    const int n = blockIdx.x, h = blockIdx.y, b = blockIdx.z, d = threadIdx.x;
    const float* kp = Z + ((size_t)(b * SEQ + n * BLK)) * NZ + 1024 + h * HD + d;
    float s = 0.f;
    for (int j = 0; j < BLK; ++j) s += kp[(size_t)j * NZ];
    kmean[((size_t)(b * NH + h) * NB + n) * HD + d] = s * (1.0f / BLK);
}

__global__ __launch_bounds__(64) void moba_attn_kernel(const float* __restrict__ Z, const float* __restrict__ kmean, float* __restrict__ O  ) {
    const int b = blockIdx.z, h = blockIdx.y, q0 = blockIdx.x * 64, lane = threadIdx.x;
    const int qpos = q0 + lane, qblk = q0 / BLK;
    __shared__ float Ks[32][64];
    __shared__ float Vs[32][64];
    float q[64];
    {
        const float* zq = Z + ((size_t)(b * SEQ + qpos)) * NZ + 512 + h * HD;
#pragma unroll
        for (int d = 0; d < 64; ++d) q[d] = zq[d] * 0.125f;
    }
    float gate[NB];
#pragma unroll
    for (int n = 0; n < NB; ++n) {
        float gsum = -INFINITY;
        if (n < qblk) {
            const float* km = kmean + ((size_t)(b * NH + h) * NB + n) * HD;
            gsum = 0.f;
#pragma unroll
            for (int d = 0; d < 64; ++d) gsum = fmaf(q[d], km[d], gsum);
        }
        gate[n] = gsum;
    }
    unsigned selmask = 0u;
    const int nsel = qblk < 3 ? qblk : 3;
#pragma unroll
    for (int r = 0; r < 3; ++r) {
        if (r < nsel) {
            int best = 0; float bv = -INFINITY;
#pragma unroll
            for (int n = 0; n < NB; ++n) { const bool free_ = ((selmask >> n) & 1u) == 0u; if (free_ && gate[n] > bv) { bv = gate[n]; best = n; } }
            selmask |= 1u << best;
        }
    }
    float o[64];
#pragma unroll
    for (int d = 0; d < 64; ++d) o[d] = 0.f;
    float mrun = -INFINITY, lrun = 0.f;
    for (int n = 0; n <= qblk; ++n) {
        const bool own = (n == qblk);
        const bool need = own || ((selmask >> n) & 1u);
        if (!__any(need)) continue;
        for (int t = 0; t < 8; ++t) {
            const int k0 = n * BLK + t * 32;
            __syncthreads();
            for (int i = 0; i < 32; ++i) {
                const float* zr = Z + ((size_t)(b * SEQ + k0 + i)) * NZ + h * HD + lane;
                Ks[i][lane] = zr[1024]; Vs[i][lane] = zr[1536];
            }
            __syncthreads();
            if (need && (!own || k0 <= qpos)) {
                float s[32];
#pragma unroll
                for (int j = 0; j < 32; ++j) {
                    float a = 0.f;
#pragma unroll
                    for (int d = 0; d < 64; d += 4) { const float4 kv = *(const float4*)&Ks[j][d]; a = fmaf(q[d], kv.x, a); a = fmaf(q[d + 1], kv.y, a); a = fmaf(q[d + 2], kv.z, a); a = fmaf(q[d + 3], kv.w, a); }
                    if (own && (k0 + j > qpos)) a = -INFINITY;
                    s[j] = a;
                }
                float mt = s[0];
#pragma unroll
                for (int j = 1; j < 32; ++j) mt = fmaxf(mt, s[j]);
                const float mnew = fmaxf(mrun, mt);
                const float alpha = expf(mrun - mnew);
                float psum = 0.f;
#pragma unroll
                for (int j = 0; j < 32; ++j) { s[j] = expf(s[j] - mnew); psum += s[j]; }
                lrun = lrun * alpha + psum;
#pragma unroll
                for (int d = 0; d < 64; ++d) o[d] *= alpha;
#pragma unroll
                for (int j = 0; j < 32; ++j) {
#pragma unroll
                    for (int d = 0; d < 64; d += 4) { const float4 vv = *(const float4*)&Vs[j][d]; o[d] = fmaf(s[j], vv.x, o[d]); o[d + 1] = fmaf(s[j], vv.y, o[d + 1]); o[d + 2] = fmaf(s[j], vv.z, o[d + 2]); o[d + 3] = fmaf(s[j], vv.w, o[d + 3]); }
                }
                mrun = mnew;
            }
        }
    }
    const float inv = 1.0f / lrun;
    float* op = O + ((size_t)(b * SEQ + qpos)) * DATT + h * HD;
#pragma unroll
    for (int d = 0; d < 64; ++d) op[d] = o[d] * inv;
}
}

extern "C" void kernel_launch(void* const* d_in, const int* in_sizes, int n_in, void* d_out, int out_size, void* d_ws, size_t ws_size, hipStream_t stream) {
    using namespace gold;
    constexpr size_t MiB = 1u << 20;
    if (n_in != 22 || in_sizes[0] != M * DM || out_size != M * DM || ws_size < 512 * MiB) {
        fprintf(stderr, "kernel_launch: unexpected shapes (n_in %d, in0 %d, out %d, ws %zu)\n", n_in, n_in > 0 ? in_sizes[0] : -1, out_size, ws_size);
        return;
    }
    const float* x = (const float*)d_in[0];
    const float* g_pre_mix = (const float*)d_in[1];
    const float* w_in = (const float*)d_in[2];
    const float* a_re = (const float*)d_in[3];
    const float* a_im = (const float*)d_in[4];
    const float* log_dt = (const float*)d_in[5];
    const float* b_re = (const float*)d_in[6];
    const float* b_im = (const float*)d_in[7];
    const float* c_re = (const float*)d_in[8];
    const float* c_im = (const float*)d_in[9];
    const float* d_skip = (const float*)d_in[10];
    const float* w_glu = (const float*)d_in[11];
    const float* b_glu = (const float*)d_in[12];
    const float* g_ssm_out = (const float*)d_in[13];
    const float* g_attn_out = (const float*)d_in[14];
    const float* w_out = (const float*)d_in[15];
    const float* g_post_mix = (const float*)d_in[16];
    const float* g_pre_ffn = (const float*)d_in[17];
    const float* w_gate = (const float*)d_in[18];
    const float* w_up = (const float*)d_in[19];
    const float* w_down = (const float*)d_in[20];
    const float* g_post_ffn = (const float*)d_in[21];
    float* out = (float*)d_out;
    char* ws = (char*)d_ws;
    float* R0 = (float*)(ws);
    float* Z = (float*)(ws + 128 * MiB);
    float* R2 = (float*)(ws + 384 * MiB);
    float* lam = out;
    float* bbr = out + 8192;
    float* bbi = out + 8192 + 32768;
    float* kmean = out + 8192 + 65536;

    rmsnorm_kernel<<<M / 4, 256, 0, stream>>>(x, DM, g_pre_mix, nullptr, 0, R0, DM, DM);
    gemm_f32<<<dim3(NZ / 128, M / 128), 256, 0, stream>>>(R0, DM, w_in, NZ, Z, NZ, DM);
    s5_const_kernel<<<(NG * NP + 255) / 256, 256, 0, stream>>>(a_re, a_im, log_dt, b_re, b_im, lam, bbr, bbi);
    float* Y = R2;
    float* GATE = R2 + (size_t)M * DSSM;
    s5_scan_kernel<<<dim3(NG, BATCH), 64, 0, stream>>>(Z, lam, bbr, bbi, c_re, c_im, d_skip, Y);
    gemm_f32<<<dim3(DSSM / 128, M / 128), 256, 0, stream>>>(Y, DSSM, w_glu, DSSM, GATE, DSSM, DSSM);
    { const size_t n = (size_t)M * DSSM; glu_kernel<<<(unsigned)((n + 255) / 256), 256, 0, stream>>>(Y, GATE, b_glu, n); }
    rmsnorm_kernel<<<M / 4, 256, 0, stream>>>(Y, DSSM, g_ssm_out, nullptr, 0, R0, DM, DSSM);
    kmean_kernel<<<dim3(NB, NH, BATCH), 64, 0, stream>>>(Z, kmean);
    float* OA = GATE;
    moba_attn_kernel<<<dim3(SEQ / 64, NH, BATCH), 64, 0, stream>>>(Z, kmean, OA);
    rmsnorm_kernel<<<M / 4, 256, 0, stream>>>(OA, DATT, g_attn_out, nullptr, 0, R0 + DSSM, DM, DATT);
    gemm_f32<<<dim3(DM / 128, M / 128), 256, 0, stream>>>(R0, DM, w_out, DM, R2, DM, DM);
    rmsnorm_kernel<<<M / 4, 256, 0, stream>>>(R2, DM, g_post_mix, x, DM, out, DM, DM);
    rmsnorm_kernel<<<M / 4, 256, 0, stream>>>(out, DM, g_pre_ffn, nullptr, 0, R0, DM, DM);
    constexpr int CH = 4096;
    float* Gc = R2;
    float* Uc = R2 + (size_t)CH * DFF;
    float* Dc = R2 + (size_t)2 * CH * DFF;
    for (int c = 0; c < M / CH; ++c) {
        const float* h2c = R0 + (size_t)c * CH * DM;
        gemm_f32<<<dim3(DFF / 128, CH / 128), 256, 0, stream>>>(h2c, DM, w_gate, DFF, Gc, DFF, DM);
        gemm_f32<<<dim3(DFF / 128, CH / 128), 256, 0, stream>>>(h2c, DM, w_up, DFF, Uc, DFF, DM);
        { const size_t n = (size_t)CH * DFF; swiglu_kernel<<<(unsigned)((n + 255) / 256), 256, 0, stream>>>(Gc, Uc, n); }
        gemm_f32<<<dim3(DM / 128, CH / 128), 256, 0, stream>>>(Gc, DFF, w_down, DM, Dc, DM, DFF);
        float* oc = out + (size_t)c * CH * DM;
        rmsnorm_kernel<<<CH / 4, 256, 0, stream>>>(Dc, DM, g_post_ffn, oc, DM, oc, DM, DM);
    }
}
```
